# Optimizing an MI355X kernel written in HIP

```python
import math
import jax, jax.numpy as jnp
from jax import lax
import numpy as np

D_MODEL = 1024
BATCH = 4
SEQ = 4096
DEPTH = 4

HEAD_DIM = 64
GM_WIDTH = D_MODEL // 4
GM_HEADS = GM_WIDTH // HEAD_DIM
GM_CHUNK = 128
S5_WIDTH = D_MODEL // 4
S5_GROUP_DIM = 16
S5_GROUPS = S5_WIDTH // S5_GROUP_DIM
S5_STATE = 64
S5_DT_MIN = 1e-3
S5_DT_MAX = 1e-1
FOX_WIDTH = D_MODEL // 2
FOX_HEADS = FOX_WIDTH // HEAD_DIM
Q_BLOCK = 128
D_MIX = GM_WIDTH + S5_WIDTH + FOX_WIDTH
D_IN_PROJ = 2 * GM_WIDTH + S5_WIDTH + 3 * FOX_WIDTH + FOX_HEADS
IN_SPLITS = (GM_WIDTH, 2 * GM_WIDTH, 2 * GM_WIDTH + S5_WIDTH,
             2 * GM_WIDTH + S5_WIDTH + FOX_WIDTH,
             2 * GM_WIDTH + S5_WIDTH + 2 * FOX_WIDTH,
             2 * GM_WIDTH + S5_WIDTH + 3 * FOX_WIDTH)
D_FF = ((8 * D_MODEL // 3 + 127) // 128) * 128
CONV_WIDTH = 3
LN_EPS = 1e-5
DN_ALPHA = (2.0 * DEPTH) ** 0.25
DN_BETA = (8.0 * DEPTH) ** -0.25
NEG_INF = -1e30

kernel_name = "hymba_style_gmlp_s5_fox_deepnorm_trunk"


def layer_norm(x, g, b):
    xf = x.astype(jnp.float32)
    mu = jnp.mean(xf, axis=-1, keepdims=True)
    var = jnp.mean(jnp.square(xf - mu), axis=-1, keepdims=True)
    y = (xf - mu) * lax.rsqrt(var + LN_EPS)
    return (y * g.astype(jnp.float32) + b.astype(jnp.float32)).astype(x.dtype)


def gmlp_mixer(u, v, ln_g, ln_b, w_s, b_s):
    B, S, _ = u.shape
    n = S // GM_CHUNK
    v = layer_norm(v.reshape(B, S, GM_HEADS, HEAD_DIM), ln_g, ln_b)
    v = v.reshape(B, n, GM_CHUNK, GM_HEADS, HEAD_DIM)
    causal = jnp.tril(jnp.ones((GM_CHUNK, GM_CHUNK), dtype=bool))
    w = jnp.where(causal[None], w_s, jnp.zeros_like(w_s))
    z = jnp.einsum('hts,bnshd->bnthd', w, v) + b_s.T[None, None, :, :, None]
    out = u.reshape(B, n, GM_CHUNK, GM_HEADS, HEAD_DIM) * z
    return out.reshape(B, S, GM_WIDTH)


def _ssm_combine(left, right):
    a_l, b_l = left
    a_r, b_r = right
    return a_r * a_l, a_r * b_l + b_r


def s5_mixer(u, lam_re, lam_im, log_dt, b_re, b_im, c_re, c_im, d_skip, w_glu, b_glu):
    B, S, _ = u.shape
    f32 = jnp.float32
    uf = u.astype(f32).reshape(B, S, S5_GROUPS, S5_GROUP_DIM)
    lam = lax.complex(lam_re.astype(f32), lam_im.astype(f32))
    dt = jnp.exp(log_dt.astype(f32))[:, None]
    lam_bar = jnp.exp(lam * dt)
    b_mat = lax.complex(b_re.astype(f32), b_im.astype(f32))
    b_bar = ((lam_bar - 1.0) / lam)[:, :, None] * b_mat
    c_mat = lax.complex(c_re.astype(f32), c_im.astype(f32))
    bu = jnp.einsum('gph,bsgh->bsgp', b_bar, uf.astype(jnp.complex64))
    a = jnp.broadcast_to(lam_bar, bu.shape)
    _, states = lax.associative_scan(_ssm_combine, (a, bu), axis=1)
    y = jnp.real(jnp.einsum('ghp,bsgp->bsgh', c_mat, states)) + d_skip.astype(f32) * uf
    y = jax.nn.gelu(y)
    gate = jnp.einsum('gij,bsgj->bsgi', w_glu.astype(f32), y) + b_glu.astype(f32)
    out = y * jax.nn.sigmoid(gate)
    return out.reshape(B, S, S5_WIDTH).astype(u.dtype)


def fox_mixer(q, k, v, f_logit):
    B, S, _ = q.shape
    q = q.reshape(B, S, FOX_HEADS, HEAD_DIM)
    k = k.reshape(B, S, FOX_HEADS, HEAD_DIM)
    v = v.reshape(B, S, FOX_HEADS, HEAD_DIM)
    log_f = jax.nn.log_sigmoid(f_logit.astype(jnp.float32))
    cum = jnp.cumsum(log_f, axis=1).transpose(0, 2, 1)
    scale = HEAD_DIM ** -0.5
    outs = []
    for i in range(S // Q_BLOCK):
        q0, q1 = i * Q_BLOCK, (i + 1) * Q_BLOCK
        logits = jnp.einsum('bthd,bshd->bhts', q[:, q0:q1], k[:, :q1]).astype(jnp.float32) * scale
        decay = cum[:, :, q0:q1, None] - cum[:, :, None, :q1]
        causal = jnp.arange(q1)[None, :] <= (q0 + jnp.arange(Q_BLOCK))[:, None]
        logits = jnp.where(causal, logits + decay, NEG_INF)
        p = jax.nn.softmax(logits, axis=-1)
        outs.append(jnp.einsum('bhts,bshd->bthd', p.astype(v.dtype), v[:, :q1]))
    return jnp.concatenate(outs, axis=1).reshape(B, S, FOX_WIDTH)


def conv_ffn(h, w_up, conv_w, conv_b, w_down):
    S = h.shape[1]
    up = h @ w_up
    a, g = jnp.split(up, 2, axis=-1)
    a_pad = jnp.pad(a, ((0, 0), (CONV_WIDTH - 1, 0), (0, 0)))
    conv = conv_b
    for j in range(CONV_WIDTH):
        conv = conv + conv_w[j] * a_pad[:, j:j + S]
    return (jax.nn.gelu(conv) * g) @ w_down


def setup_inputs(seed: int = 0) -> dict:
    key = jax.random.key(seed)
    ks = jax.random.split(key, 32)
    f32 = jnp.float32
    L, D = DEPTH, D_MODEL
    nrm = lambda k, shape, s: jax.random.normal(k, shape, f32) * s
    n_idx = jnp.arange(S5_STATE, dtype=f32)
    return {
        "x": jax.random.normal(ks[0], (BATCH, SEQ, D), f32),
        "c": jax.random.normal(ks[1], (BATCH, D), f32),
        "w_ada": nrm(ks[2], (L, D, 6 * D), 0.1 * D ** -0.5),
        "b_ada": nrm(ks[3], (L, 6 * D), 0.01),
        "w_in": nrm(ks[4], (L, D, D_IN_PROJ), D ** -0.5),
        "b_f": jax.random.uniform(ks[5], (L, FOX_HEADS), f32, 1.0, 3.0),
        "gm_ln_g": 1.0 + nrm(ks[6], (L, GM_HEADS, HEAD_DIM), 0.02),
        "gm_ln_b": nrm(ks[7], (L, GM_HEADS, HEAD_DIM), 0.02),
        "gm_w_s": nrm(ks[8], (L, GM_HEADS, GM_CHUNK, GM_CHUNK), GM_CHUNK ** -0.5),
        "gm_b_s": 1.0 + nrm(ks[9], (L, GM_HEADS, GM_CHUNK), 0.02),
        "s5_lam_re": -0.5 + nrm(ks[10], (L, S5_GROUPS, S5_STATE), 0.01),
        "s5_lam_im": math.pi * n_idx + nrm(ks[11], (L, S5_GROUPS, S5_STATE), 0.01),
        "s5_log_dt": jax.random.uniform(ks[12], (L, S5_GROUPS), f32,
                                        math.log(S5_DT_MIN), math.log(S5_DT_MAX)),
        "s5_b_re": nrm(ks[13], (L, S5_GROUPS, S5_STATE, S5_GROUP_DIM), (2 * S5_GROUP_DIM) ** -0.5),
        "s5_b_im": nrm(ks[14], (L, S5_GROUPS, S5_STATE, S5_GROUP_DIM), (2 * S5_GROUP_DIM) ** -0.5),
        "s5_c_re": nrm(ks[15], (L, S5_GROUPS, S5_GROUP_DIM, S5_STATE), (2 * S5_STATE) ** -0.5),
        "s5_c_im": nrm(ks[16], (L, S5_GROUPS, S5_GROUP_DIM, S5_STATE), (2 * S5_STATE) ** -0.5),
        "s5_d": nrm(ks[17], (L, S5_GROUPS, S5_GROUP_DIM), 1.0),
        "s5_w_glu": nrm(ks[18], (L, S5_GROUPS, S5_GROUP_DIM, S5_GROUP_DIM), S5_GROUP_DIM ** -0.5),
        "s5_b_glu": nrm(ks[19], (L, S5_GROUPS, S5_GROUP_DIM), 0.02),
        "w_out": nrm(ks[20], (L, D_MIX, D), DN_BETA * D_MIX ** -0.5),
        "ln1_g": 1.0 + nrm(ks[21], (L, D), 0.02),
        "ln1_b": nrm(ks[22], (L, D), 0.02),
        "w_up": nrm(ks[23], (L, D, 2 * D_FF), D ** -0.5),
        "conv_w": nrm(ks[24], (L, CONV_WIDTH, D_FF), CONV_WIDTH ** -0.5),
        "conv_b": nrm(ks[25], (L, D_FF), 0.02),
        "w_down": nrm(ks[26], (L, D_FF, D), DN_BETA * D_FF ** -0.5),
        "ln2_g": 1.0 + nrm(ks[27], (L, D), 0.02),
        "ln2_b": nrm(ks[28], (L, D), 0.02),
    }


def reference(x, c, w_ada, b_ada, w_in, b_f, gm_ln_g, gm_ln_b, gm_w_s, gm_b_s,
              s5_lam_re, s5_lam_im, s5_log_dt, s5_b_re, s5_b_im, s5_c_re, s5_c_im,
              s5_d, s5_w_glu, s5_b_glu, w_out, ln1_g, ln1_b, w_up, conv_w, conv_b,
              w_down, ln2_g, ln2_b):
    cond = jax.nn.silu(c)
    for l in range(DEPTH):
        mod = (cond @ w_ada[l] + b_ada[l])[:, None, :]
        sh1, sc1, g1, sh2, sc2, g2 = jnp.split(mod, 6, axis=-1)

        h = x * (1.0 + sc1) + sh1
        p = h @ w_in[l]
        gm_u, gm_v, s5_in, fq, fk, fv, ff = jnp.split(p, IN_SPLITS, axis=-1)
        y_gm = gmlp_mixer(gm_u, gm_v, gm_ln_g[l], gm_ln_b[l], gm_w_s[l], gm_b_s[l])
        y_s5 = s5_mixer(s5_in, s5_lam_re[l], s5_lam_im[l], s5_log_dt[l], s5_b_re[l], s5_b_im[l],
                        s5_c_re[l], s5_c_im[l], s5_d[l], s5_w_glu[l], s5_b_glu[l])
        y_fox = fox_mixer(fq, fk, fv, ff + b_f[l])
        mix = jnp.concatenate([y_gm, y_s5, y_fox], axis=-1) @ w_out[l]
        x = layer_norm(DN_ALPHA * x + (1.0 + g1) * mix, ln1_g[l], ln1_b[l])

        h = x * (1.0 + sc2) + sh2
        ffn = conv_ffn(h, w_up[l], conv_w[l], conv_b[l], w_down[l])
        x = layer_norm(DN_ALPHA * x + (1.0 + g2) * ffn, ln2_g[l], ln2_b[l])
    return x
```

```cpp
#include <hip/hip_runtime.h>
#include <cstdio>
#include <cstdint>
#include <cmath>

namespace nv {
constexpr int B = 4, S = 4096, D = 1024, L = 4, M = B * S;
constexpr int GMW = 256, GMH = 4, HD = 64, CH = 128;
constexpr int S5W = 256, S5G = 16, S5H = 16, S5P = 64;
constexpr int FXW = 512, FXH = 8;
constexpr int DMIX = 1024, DIN = 2312;
constexpr int O_U = 0, O_V = 256, O_S5 = 512, O_Q = 768, O_K = 1280, O_VV = 1792, O_F = 2304;
constexpr int DFF = 2816, DUP = 5632;
constexpr float LN_EPS = 1e-5f;
constexpr float ALPHA = 1.681792830507429f;

__device__ __forceinline__ float gelu_tanh(float x) {
    const float u = 0.7978845608028654f * (x + 0.044715f * x * x * x);
    return 0.5f * x * (1.f + tanhf(u));
}
__device__ __forceinline__ float sigmoidf_(float x) { return 1.f / (1.f + expf(-x)); }
__device__ __forceinline__ float log_sigmoid(float x) { return fminf(x, 0.f) - log1pf(expf(-fabsf(x))); }

__global__ void k_mod(const float* __restrict__ c, const float* __restrict__ w_ada, const float* __restrict__ b_ada, float* __restrict__ mod) {
    const int idx = blockIdx.x * blockDim.x + threadIdx.x;
    if (idx >= L * B * 6 * D) return;
    const int j = idx % (6 * D), b = (idx / (6 * D)) % B, l = idx / (6 * D * B);
    const float* w = w_ada + (size_t)l * D * 6 * D + j;
    float acc = 0.f;
    for (int k = 0; k < D; ++k) { const float cv = c[b * D + k]; const float sv = cv / (1.f + expf(-cv)); acc += sv * w[(size_t)k * 6 * D]; }
    mod[idx] = acc + b_ada[l * 6 * D + j];
}
__global__ void k_modulate(const float* __restrict__ x, const float* __restrict__ modl, int off_sh, int off_sc, float* __restrict__ h) {
    const size_t idx = (size_t)blockIdx.x * blockDim.x + threadIdx.x;
    if (idx >= (size_t)M * D) return;
    const int d = idx % D; const int b = (int)(idx / ((size_t)S * D));
    h[idx] = x[idx] * (1.f + modl[b * 6 * D + off_sc + d]) + modl[b * 6 * D + off_sh + d];
}
__global__ void __launch_bounds__(256) k_gemm(const float* __restrict__ A, int lda, const float* __restrict__ Bm, int ldb, float* __restrict__ C, int ldc, int Mr, int N, int K) {
    __shared__ float As[16][64 + 4];
    __shared__ float Bs[16][64 + 4];
    const int tid = threadIdx.x, tx = tid % 16, ty = tid / 16;
    const int m0 = blockIdx.y * 64, n0 = blockIdx.x * 64;
    float acc[4][4] = {};
    for (int k0 = 0; k0 < K; k0 += 16) {
        { const int r = tid / 4, kk = (tid % 4) * 4; const float4 v = *(const float4*)(A + (size_t)(m0 + r) * lda + k0 + kk);
          As[kk + 0][r] = v.x; As[kk + 1][r] = v.y; As[kk + 2][r] = v.z; As[kk + 3][r] = v.w; }
        { const int kk = tid / 16, n = (tid % 16) * 4; float4 v = make_float4(0.f, 0.f, 0.f, 0.f);
          if (n0 + n < N) v = *(const float4*)(Bm + (size_t)(k0 + kk) * ldb + n0 + n);
          Bs[kk][n + 0] = v.x; Bs[kk][n + 1] = v.y; Bs[kk][n + 2] = v.z; Bs[kk][n + 3] = v.w; }
        __syncthreads();
#pragma unroll
        for (int kk = 0; kk < 16; ++kk) {
            float a[4], b[4];
#pragma unroll
            for (int i = 0; i < 4; ++i) { a[i] = As[kk][ty * 4 + i]; b[i] = Bs[kk][tx * 4 + i]; }
#pragma unroll
            for (int i = 0; i < 4; ++i)
#pragma unroll
                for (int j = 0; j < 4; ++j) acc[i][j] += a[i] * b[j];
        }
        __syncthreads();
    }
    if (n0 + tx * 4 < N) {
#pragma unroll
        for (int i = 0; i < 4; ++i) *(float4*)(C + (size_t)(m0 + ty * 4 + i) * ldc + n0 + tx * 4) = make_float4(acc[i][0], acc[i][1], acc[i][2], acc[i][3]);
    }
}
__global__ void k_gm_vnorm(const float* __restrict__ p, const float* __restrict__ g, const float* __restrict__ bb, float* __restrict__ vn) {
    const int w = (blockIdx.x * blockDim.x + threadIdx.x) / 64, lane = threadIdx.x % 64;
    if (w >= M * GMH) return;
    const int m = w / GMH, h = w % GMH;
    const float v = p[(size_t)m * DIN + O_V + h * 64 + lane];
    float s = v;
    for (int o = 1; o < 64; o <<= 1) s += __shfl_xor(s, o);
    const float mu = s * (1.f / 64.f), dv = v - mu;
    float q = dv * dv;
    for (int o = 1; o < 64; o <<= 1) q += __shfl_xor(q, o);
    const float r = rsqrtf(q * (1.f / 64.f) + LN_EPS);
    vn[(size_t)m * GMW + h * 64 + lane] = dv * r * g[h * 64 + lane] + bb[h * 64 + lane];
}
__global__ void k_gm_mix(const float* __restrict__ p, const float* __restrict__ vn, const float* __restrict__ ws_, const float* __restrict__ bs, float* __restrict__ y) {
    const size_t idx = (size_t)blockIdx.x * blockDim.x + threadIdx.x;
    if (idx >= (size_t)M * GMW) return;
    const int col = idx % GMW, m = (int)(idx / GMW), h = col / 64, t = m % CH, mb = m - t;
    const float* w = ws_ + ((size_t)h * CH + t) * CH;
    float z = bs[h * CH + t];
    for (int s = 0; s <= t; ++s) z += w[s] * vn[(size_t)(mb + s) * GMW + col];
    y[(size_t)m * DMIX + col] = p[(size_t)m * DIN + O_U + col] * z;
}
__global__ void __launch_bounds__(64) k_s5(const float* __restrict__ p, const float* __restrict__ lam_re, const float* __restrict__ lam_im, const float* __restrict__ log_dt,
                     const float* __restrict__ b_re, const float* __restrict__ b_im, const float* __restrict__ c_re, const float* __restrict__ c_im,
                     const float* __restrict__ dsk, const float* __restrict__ wglu, const float* __restrict__ bglu, float* __restrict__ y) {
    const int b = blockIdx.x / S5G, g = blockIdx.x % S5G, lane = threadIdx.x;
    const double lr = lam_re[g * S5P + lane], li = lam_im[g * S5P + lane], dt = exp((double)log_dt[g]);
    const double er = exp(lr * dt), lbr = er * cos(li * dt), lbi = er * sin(li * dt);
    const double nr = lbr - 1.0, ni = lbi, den = lr * lr + li * li;
    const double fr = (nr * lr + ni * li) / den, fi = (ni * lr - nr * li) / den;
    float bbr[16], bbi[16], cr[16], ci[16];
#pragma unroll
    for (int h = 0; h < 16; ++h) {
        const double br = b_re[((size_t)g * S5P + lane) * S5H + h], bi = b_im[((size_t)g * S5P + lane) * S5H + h];
        bbr[h] = (float)(fr * br - fi * bi); bbi[h] = (float)(fr * bi + fi * br);
        cr[h] = c_re[((size_t)g * S5H + h) * S5P + lane]; ci[h] = c_im[((size_t)g * S5H + h) * S5P + lane];
    }
    const float alr = (float)lbr, ali = (float)lbi;
    float xr = 0.f, xi = 0.f;
    float wg[16]; float dl = 0.f, bg = 0.f;
    if (lane < 16) { for (int j = 0; j < 16; ++j) wg[j] = wglu[((size_t)g * 16 + lane) * 16 + j]; dl = dsk[g * 16 + lane]; bg = bglu[g * 16 + lane]; }
    else { for (int j = 0; j < 16; ++j) wg[j] = 0.f; }
    for (int t = 0; t < S; ++t) {
        const float* ur = p + (size_t)(b * S + t) * DIN + O_S5 + g * 16;
        float u[16];
#pragma unroll
        for (int h = 0; h < 16; ++h) u[h] = ur[h];
        float bur = 0.f, bui = 0.f;
#pragma unroll
        for (int h = 0; h < 16; ++h) { bur += bbr[h] * u[h]; bui += bbi[h] * u[h]; }
        const float nxr = alr * xr - ali * xi + bur, nxi = alr * xi + ali * xr + bui;
        xr = nxr; xi = nxi;
        float yv[16];
#pragma unroll
        for (int h = 0; h < 16; ++h) {
            float v = cr[h] * xr - ci[h] * xi;
            for (int o = 1; o < 64; o <<= 1) v += __shfl_xor(v, o);
            yv[h] = gelu_tanh(v + dsk[g * 16 + h] * u[h]);
        }
        float gate = bg, yi = 0.f;
#pragma unroll
        for (int j = 0; j < 16; ++j) { gate += wg[j] * yv[j]; if (lane == j) yi = yv[j]; }
        if (lane < 16) y[(size_t)(b * S + t) * DMIX + GMW + g * 16 + lane] = yi * sigmoidf_(gate);
        (void)dl;
    }
}
__global__ void __launch_bounds__(256) k_fcum(const float* __restrict__ p, const float* __restrict__ bf, float* __restrict__ F) {
    __shared__ float part[256];
    const int idx = blockIdx.x, b = idx / FXH, h = idx % FXH, tid = threadIdx.x;
    float v[16]; float acc = 0.f;
#pragma unroll
    for (int i = 0; i < 16; ++i) { acc += log_sigmoid(p[(size_t)(b * S + tid * 16 + i) * DIN + O_F + h] + bf[h]); v[i] = acc; }
    part[tid] = acc;
    __syncthreads();
    float base = 0.f;
    for (int j = 0; j < tid; ++j) base += part[j];
#pragma unroll
    for (int i = 0; i < 16; ++i) F[(size_t)idx * S + tid * 16 + i] = base + v[i];
}
__global__ void __launch_bounds__(64) k_fox(const float* __restrict__ p, const float* __restrict__ F, float* __restrict__ y) {
    const int t = blockIdx.x * 64 + threadIdx.x, h = blockIdx.y, b = blockIdx.z;
    float q[64], o[64];
    const float* qp = p + (size_t)(b * S + t) * DIN + O_Q + h * 64;
#pragma unroll
    for (int d = 0; d < 64; ++d) { q[d] = qp[d] * 0.125f; o[d] = 0.f; }
    const float* Fb = F + (size_t)(b * FXH + h) * S;
    const float Ft = Fb[t];
    float mx = -1e30f, l = 0.f;
    const int tmax = blockIdx.x * 64 + 63;
    for (int s = 0; s <= tmax; ++s) {
        const float* kp = p + (size_t)(b * S + s) * DIN + O_K + h * 64;
        const float* vp = p + (size_t)(b * S + s) * DIN + O_VV + h * 64;
        float dot = 0.f;
#pragma unroll
        for (int d = 0; d < 64; ++d) dot += q[d] * kp[d];
        if (s <= t) {
            const float lg = dot + Ft - Fb[s];
            const float mn = fmaxf(mx, lg), sc = expf(mx - mn), pe = expf(lg - mn);
            l = l * sc + pe;
#pragma unroll
            for (int d = 0; d < 64; ++d) o[d] = o[d] * sc + pe * vp[d];
            mx = mn;
        }
    }
    const float il = 1.f / l;
    float* yp = y + (size_t)(b * S + t) * DMIX + GMW + S5W + h * 64;
#pragma unroll
    for (int d = 0; d < 64; ++d) yp[d] = o[d] * il;
}
__global__ void __launch_bounds__(256) k_ln(const float* __restrict__ xin, const float* __restrict__ r, const float* __restrict__ modl, int off_g,
                                          const float* __restrict__ g, const float* __restrict__ bb, float* __restrict__ xout) {
    __shared__ float red[8];
    const int m = blockIdx.x, b = m / S, tid = threadIdx.x;
    float v[4]; float s = 0.f;
#pragma unroll
    for (int i = 0; i < 4; ++i) { const int d = tid + 256 * i; v[i] = ALPHA * xin[(size_t)m * D + d] + (1.f + modl[b * 6 * D + off_g + d]) * r[(size_t)m * D + d]; s += v[i]; }
    for (int o = 1; o < 64; o <<= 1) s += __shfl_xor(s, o);
    if ((tid & 63) == 0) red[tid >> 6] = s;
    __syncthreads();
    const float mu = (red[0] + red[1] + red[2] + red[3]) * (1.f / D);
    float q = 0.f;
#pragma unroll
    for (int i = 0; i < 4; ++i) { v[i] -= mu; q += v[i] * v[i]; }
    for (int o = 1; o < 64; o <<= 1) q += __shfl_xor(q, o);
    if ((tid & 63) == 0) red[4 + (tid >> 6)] = q;
    __syncthreads();
    const float rs = rsqrtf((red[4] + red[5] + red[6] + red[7]) * (1.f / D) + LN_EPS);
#pragma unroll
    for (int i = 0; i < 4; ++i) { const int d = tid + 256 * i; xout[(size_t)m * D + d] = v[i] * rs * g[d] + bb[d]; }
}
__global__ void k_convgate(const float* __restrict__ up, const float* __restrict__ cw, const float* __restrict__ cb, float* __restrict__ hid) {
    const size_t idx = (size_t)blockIdx.x * blockDim.x + threadIdx.x;
    if (idx >= (size_t)S * DFF) return;
    const int c = idx % DFF, t = (int)(idx / DFF);
    float cv = cb[c] + cw[2 * DFF + c] * up[(size_t)t * DUP + c];
    if (t >= 1) cv += cw[1 * DFF + c] * up[(size_t)(t - 1) * DUP + c];
    if (t >= 2) cv += cw[0 * DFF + c] * up[(size_t)(t - 2) * DUP + c];
    hid[idx] = gelu_tanh(cv) * up[(size_t)t * DUP + DFF + c];
}
}

extern "C" void kernel_launch(void* const* d_in, const int* in_sizes, int n_in, void* d_out, int out_size, void* d_ws, size_t ws_size, hipStream_t stream) {
    using namespace nv;
    const float* x = (const float*)d_in[0]; const float* c = (const float*)d_in[1]; const float* w_ada = (const float*)d_in[2]; const float* b_ada = (const float*)d_in[3];
    const float* w_in = (const float*)d_in[4]; const float* b_f = (const float*)d_in[5]; const float* gm_ln_g = (const float*)d_in[6]; const float* gm_ln_b = (const float*)d_in[7];
    const float* gm_w_s = (const float*)d_in[8]; const float* gm_b_s = (const float*)d_in[9]; const float* s5_lam_re = (const float*)d_in[10]; const float* s5_lam_im = (const float*)d_in[11];
    const float* s5_log_dt = (const float*)d_in[12]; const float* s5_b_re = (const float*)d_in[13]; const float* s5_b_im = (const float*)d_in[14]; const float* s5_c_re = (const float*)d_in[15];
    const float* s5_c_im = (const float*)d_in[16]; const float* s5_d = (const float*)d_in[17]; const float* s5_w_glu = (const float*)d_in[18]; const float* s5_b_glu = (const float*)d_in[19];
    const float* w_out = (const float*)d_in[20]; const float* ln1_g = (const float*)d_in[21]; const float* ln1_b = (const float*)d_in[22]; const float* w_up = (const float*)d_in[23];
    const float* conv_w = (const float*)d_in[24]; const float* conv_b = (const float*)d_in[25]; const float* w_down = (const float*)d_in[26]; const float* ln2_g = (const float*)d_in[27];
    const float* ln2_b = (const float*)d_in[28];
    float* out = (float*)d_out;
    char* ws = (char*)d_ws;
    const size_t MiB = 1u << 20;
    float* mod = (float*)(ws);
    float* hbuf = (float*)(ws + 1 * MiB);
    float* pbuf = (float*)(ws + 65 * MiB);
    float* vn = (float*)(ws + 218 * MiB);
    float* Fc = (float*)(ws + 234 * MiB);
    float* ycat = (float*)(ws + 235 * MiB);
    if (ws_size < 300 * MiB) { fprintf(stderr, "workspace too small: %zu\n", ws_size); return; }
    float* upb = pbuf; float* hidb = pbuf + (size_t)S * DUP;

    k_mod<<<(L * B * 6 * D + 255) / 256, 256, 0, stream>>>(c, w_ada, b_ada, mod);
    for (int l = 0; l < L; ++l) {
        const float* xin = (l == 0) ? x : out;
        const float* modl = mod + (size_t)l * B * 6 * D;
        k_modulate<<<(M * D) / 256, 256, 0, stream>>>(xin, modl, 0, D, hbuf);
        k_gemm<<<dim3((DIN + 63) / 64, M / 64), 256, 0, stream>>>(hbuf, D, w_in + (size_t)l * D * DIN, DIN, pbuf, DIN, M, DIN, D);
        k_gm_vnorm<<<(M * GMH * 64) / 256, 256, 0, stream>>>(pbuf, gm_ln_g + l * GMW, gm_ln_b + l * GMW, vn);
        k_gm_mix<<<(M * GMW) / 256, 256, 0, stream>>>(pbuf, vn, gm_w_s + (size_t)l * GMH * CH * CH, gm_b_s + l * GMH * CH, ycat);
        k_s5<<<B * S5G, 64, 0, stream>>>(pbuf, s5_lam_re + l * S5G * S5P, s5_lam_im + l * S5G * S5P, s5_log_dt + l * S5G, s5_b_re + (size_t)l * S5G * S5P * S5H, s5_b_im + (size_t)l * S5G * S5P * S5H,
                                        s5_c_re + (size_t)l * S5G * S5H * S5P, s5_c_im + (size_t)l * S5G * S5H * S5P, s5_d + l * S5G * S5H, s5_w_glu + (size_t)l * S5G * 256, s5_b_glu + l * S5G * S5H, ycat);
        k_fcum<<<B * FXH, 256, 0, stream>>>(pbuf, b_f + l * FXH, Fc);
        k_fox<<<dim3(S / 64, FXH, B), 64, 0, stream>>>(pbuf, Fc, ycat);
        k_gemm<<<dim3(D / 64, M / 64), 256, 0, stream>>>(ycat, DMIX, w_out + (size_t)l * DMIX * D, D, hbuf, D, M, D, DMIX);
        k_ln<<<M, 256, 0, stream>>>(xin, hbuf, modl, 2 * D, ln1_g + l * D, ln1_b + l * D, out);
        k_modulate<<<(M * D) / 256, 256, 0, stream>>>(out, modl, 3 * D, 4 * D, hbuf);
        for (int b = 0; b < B; ++b) {
            k_gemm<<<dim3(DUP / 64, S / 64), 256, 0, stream>>>(hbuf + (size_t)b * S * D, D, w_up + (size_t)l * D * DUP, DUP, upb, DUP, S, DUP, D);
            k_convgate<<<(S * DFF) / 256, 256, 0, stream>>>(upb, conv_w + (size_t)l * 3 * DFF, conv_b + l * DFF, hidb);
            k_gemm<<<dim3(D / 64, S / 64), 256, 0, stream>>>(hidb, DFF, w_down + (size_t)l * DFF * D, D, ycat + (size_t)b * S * D, D, S, D, DFF);
        }
        k_ln<<<M, 256, 0, stream>>>(out, ycat, modl, 5 * D, ln2_g + l * D, ln2_b + l * D, out);
    }
}
```
